# Optimizing an MI355X kernel written in HIP

```python
import math
import jax, jax.numpy as jnp
from jax import lax
import numpy as np

D_MODEL = 1024
BATCH = 32
SEQ = 2048
DEPTH = 2
DEC_BATCH = 8
DEC_SEQ = 32
PAST_LEN = 2048

CHUNK = 64
N_RET_HEADS = 4
RET_DK = 128
RET_DV = 256
RET_ROPE_THETA = 10000.0
N_DIFF_HEADS = 8
DIFF_HD = 64
DIFF_ROT = DIFF_HD // 4
ROPE_THETA = 500000.0
Q_BLOCK = 128
D_FF = 2816
CONV_W = 3
EPS = 1e-6

RET_QK = N_RET_HEADS * RET_DK
RET_V = N_RET_HEADS * RET_DV
DIFF_W = N_DIFF_HEADS * 2 * DIFF_HD
SPLITS = (RET_QK, RET_QK, RET_V, RET_V, DIFF_W, DIFF_W, DIFF_W, D_MODEL, D_MODEL)
IN_W = sum(SPLITS)

kernel_name = 'hybrid_retention_diffattn_streaming_step'


def rmsnorm(x, g):
    xf = x.astype(jnp.float32)
    y = xf * lax.rsqrt(jnp.mean(xf * xf, axis=-1, keepdims=True) + EPS)
    return (y * g.astype(jnp.float32)).astype(x.dtype)


def rope(x, pos, rot_dim, theta):
    half = rot_dim // 2
    inv = theta ** (-jnp.arange(half, dtype=jnp.float32) / half)
    ang = pos.astype(jnp.float32)[:, None] * inv[None, :]
    shape = (ang.shape[0],) + (1,) * (x.ndim - 3) + (half,)
    cos = jnp.cos(ang).reshape(shape).astype(x.dtype)
    sin = jnp.sin(ang).reshape(shape).astype(x.dtype)
    xr, xp = x[..., :rot_dim], x[..., rot_dim:]
    x1, x2 = xr[..., :half], xr[..., half:]
    return jnp.concatenate([x1 * cos - x2 * sin, x2 * cos + x1 * sin, xp], axis=-1)


def ret_log_decay():
    return jnp.log1p(-jnp.exp2(-5.0 - jnp.arange(N_RET_HEADS, dtype=jnp.float32)))


def retention_chunk(S, q, k, v):
    L = q.shape[1]
    log_g = ret_log_decay()
    idx = jnp.arange(L, dtype=jnp.float32)
    rel = idx[:, None] - idx[None, :]
    decay = jnp.where(rel >= 0, jnp.exp(log_g[:, None, None] * jnp.maximum(rel, 0.0)), 0.0)
    xi = jnp.exp(log_g[None, :] * (idx[:, None] + 1.0))
    zeta = jnp.exp(log_g[None, :] * (L - 1.0 - idx[:, None]))
    g_len = jnp.exp(log_g * L)
    scores = jnp.einsum('bihd,bjhd->bhij', q, k) * decay.astype(q.dtype)
    o = (jnp.einsum('bhij,bjhe->bihe', scores, v)
         + jnp.einsum('bihd,bhde->bihe', q, S) * xi[None, :, :, None].astype(q.dtype))
    S_new = (S * g_len[None, :, None, None].astype(S.dtype)
             + jnp.einsum('bjhd,bjhe->bhde', k * zeta[None, :, :, None].astype(k.dtype), v))
    return o, S_new.astype(S.dtype)


def retention_prompt(q, k, v):
    B, T = q.shape[:2]
    nc = T // CHUNK
    qc = jnp.moveaxis(q.reshape(B, nc, CHUNK, N_RET_HEADS, RET_DK), 1, 0)
    kc = jnp.moveaxis(k.reshape(B, nc, CHUNK, N_RET_HEADS, RET_DK), 1, 0)
    vc = jnp.moveaxis(v.reshape(B, nc, CHUNK, N_RET_HEADS, RET_DV), 1, 0)
    S0 = jnp.zeros((B, N_RET_HEADS, RET_DK, RET_DV), v.dtype)

    def step(S, xs):
        o, S = retention_chunk(S, xs[0], xs[1], xs[2])
        return S, o

    S_fin, o = lax.scan(step, S0, (qc, kc, vc))
    return jnp.moveaxis(o, 0, 1).reshape(B, T, N_RET_HEADS, RET_DV), S_fin


def diff_attn_block(q, qpos, k, v, kpos, lam):
    s = jnp.einsum('bqhcd,bkhcd->bhcqk', q, k).astype(jnp.float32) * (DIFF_HD ** -0.5)
    visible = (kpos // CHUNK)[None, :] <= (qpos // CHUNK)[:, None]
    s = jnp.where(visible, s, -jnp.inf)
    p = jax.nn.softmax(s, axis=-1)
    a = p[:, :, 0] - lam * p[:, :, 1]
    return jnp.einsum('bhqk,bkhe->bqhe', a.astype(v.dtype), v)


def diff_lambda(p, lam_init):
    f32 = jnp.float32
    return (jnp.exp(jnp.sum(p['lambda_q1'].astype(f32) * p['lambda_k1'].astype(f32)))
            - jnp.exp(jnp.sum(p['lambda_q2'].astype(f32) * p['lambda_k2'].astype(f32))) + lam_init)


def mixer_inputs(h, pos, p):
    B, L = h.shape[:2]
    points = [int(c) for c in np.cumsum(SPLITS)[:-1]]
    q_r, k_r, v_r, g_r, q_d, k_d, v_d, ga, gb = jnp.split(h @ p['w_in'], points, axis=-1)
    q_r = rope(q_r.reshape(B, L, N_RET_HEADS, RET_DK), pos, RET_DK, RET_ROPE_THETA)
    k_r = rope(k_r.reshape(B, L, N_RET_HEADS, RET_DK), pos, RET_DK, RET_ROPE_THETA) * (RET_DK ** -0.5)
    v_r = v_r.reshape(B, L, N_RET_HEADS, RET_DV)
    q_d = rope(rmsnorm(q_d.reshape(B, L, N_DIFF_HEADS, 2, DIFF_HD), p['q_norm_g']), pos, DIFF_ROT, ROPE_THETA)
    k_d = rope(rmsnorm(k_d.reshape(B, L, N_DIFF_HEADS, 2, DIFF_HD), p['k_norm_g']), pos, DIFF_ROT, ROPE_THETA)
    v_d = v_d.reshape(B, L, N_DIFF_HEADS, 2 * DIFF_HD)
    return (q_r, k_r, v_r, g_r), (q_d, k_d, v_d), (ga, gb)


def mixer_output(o_r, g_r, o_d, ga, gb, p, lam_init):
    B, L = o_r.shape[:2]
    ret = rmsnorm(o_r, p['ret_norm_g']).reshape(B, L, RET_V) * jax.nn.silu(g_r)
    dif = (rmsnorm(o_d, p['diff_norm_g']) * (1.0 - lam_init)).reshape(B, L, DIFF_W)
    y = jax.nn.sigmoid(ga) * (ret @ p['w_branch_a']) + jax.nn.sigmoid(gb) * (dif @ p['w_branch_b'])
    return y @ p['w_out']


def conv_glu(h, prev, p):
    u = h @ p['w_up']
    L = u.shape[1]
    pad = jnp.concatenate([prev, u], axis=1)
    c = p['conv_b'] + p['conv_w'][0] * pad[:, 0:L]
    for j in range(1, CONV_W):
        c = c + p['conv_w'][j] * pad[:, j:j + L]
    a, g = jnp.split(c, 2, axis=-1)
    return (jax.nn.silu(g) * a) @ p['w_down'], pad[:, -(CONV_W - 1):]


def layer_prompt(x, pos, p, lam_init):
    B, T = x.shape[:2]
    h = rmsnorm(x, p['norm1_g'])
    (q_r, k_r, v_r, g_r), (q_d, k_d, v_d), (ga, gb) = mixer_inputs(h, pos, p)
    o_r, S = retention_prompt(q_r, k_r, v_r)
    lam = diff_lambda(p, lam_init)
    nb = T // Q_BLOCK
    qb = jnp.moveaxis(q_d.reshape(B, nb, Q_BLOCK, N_DIFF_HEADS, 2, DIFF_HD), 1, 0)
    pb = pos.reshape(nb, Q_BLOCK)
    o_d = lax.map(lambda a: diff_attn_block(a[0], a[1], k_d, v_d, pos, lam), (qb, pb))
    o_d = jnp.moveaxis(o_d, 0, 1).reshape(B, T, N_DIFF_HEADS, 2 * DIFF_HD)
    x = x + mixer_output(o_r, g_r, o_d, ga, gb, p, lam_init)
    f, conv_state = conv_glu(rmsnorm(x, p['norm2_g']), jnp.zeros((B, CONV_W - 1, 2 * D_FF), x.dtype), p)
    return x + f, (k_d.reshape(B, T, N_DIFF_HEADS, 2 * DIFF_HD), v_d, S, conv_state)


def layer_sample(x, pos, ck, cv, s_ret, s_conv, p, lam_init):
    B, L = x.shape[:2]
    past = ck.shape[1]
    h = rmsnorm(x, p['norm1_g'])
    (q_r, k_r, v_r, g_r), (q_d, k_d, v_d), (ga, gb) = mixer_inputs(h, pos, p)
    o_r, S = retention_chunk(s_ret, q_r, k_r, v_r)
    lam = diff_lambda(p, lam_init)
    k_all = jnp.concatenate([ck.reshape(B, past, N_DIFF_HEADS, 2, DIFF_HD), k_d], axis=1)
    v_all = jnp.concatenate([cv, v_d], axis=1)
    kpos = jnp.arange(past + L, dtype=jnp.int32)
    o_d = diff_attn_block(q_d, pos, k_all, v_all, kpos, lam)
    x = x + mixer_output(o_r, g_r, o_d, ga, gb, p, lam_init)
    f, conv_state = conv_glu(rmsnorm(x, p['norm2_g']), s_conv, p)
    return x + f, (k_d.reshape(B, L, N_DIFF_HEADS, 2 * DIFF_HD), v_d, S, conv_state)


def setup_inputs(seed: int = 0) -> dict:
    key = jax.random.key(seed)
    ks = jax.random.split(key, 24)

    def nrm(k, shape, scale):
        return jax.random.normal(k, shape, jnp.float32) * scale

    return {
        'x_prompt': nrm(ks[0], (BATCH, SEQ, D_MODEL), 1.0),
        'x_sample': nrm(ks[1], (DEC_BATCH, DEC_SEQ, D_MODEL), 1.0),
        'cache_k': nrm(ks[2], (DEPTH, DEC_BATCH, PAST_LEN, N_DIFF_HEADS, 2 * DIFF_HD), 1.0),
        'cache_v': nrm(ks[3], (DEPTH, DEC_BATCH, PAST_LEN, N_DIFF_HEADS, 2 * DIFF_HD), 1.0),
        'state_ret': nrm(ks[4], (DEPTH, DEC_BATCH, N_RET_HEADS, RET_DK, RET_DV), 0.5),
        'state_conv': nrm(ks[5], (DEPTH, DEC_BATCH, CONV_W - 1, 2 * D_FF), 1.0),
        'norm1_g': 1.0 + nrm(ks[6], (DEPTH, D_MODEL), 0.05),
        'w_in': nrm(ks[7], (DEPTH, D_MODEL, IN_W), D_MODEL ** -0.5),
        'ret_norm_g': 1.0 + nrm(ks[8], (DEPTH, RET_DV), 0.05),
        'q_norm_g': 1.0 + nrm(ks[9], (DEPTH, DIFF_HD), 0.05),
        'k_norm_g': 1.0 + nrm(ks[10], (DEPTH, DIFF_HD), 0.05),
        'lambda_q1': nrm(ks[11], (DEPTH, DIFF_HD), 0.1),
        'lambda_k1': nrm(ks[12], (DEPTH, DIFF_HD), 0.1),
        'lambda_q2': nrm(ks[13], (DEPTH, DIFF_HD), 0.1),
        'lambda_k2': nrm(ks[14], (DEPTH, DIFF_HD), 0.1),
        'diff_norm_g': 1.0 + nrm(ks[15], (DEPTH, 2 * DIFF_HD), 0.05),
        'w_branch_a': nrm(ks[16], (DEPTH, RET_V, D_MODEL), RET_V ** -0.5),
        'w_branch_b': nrm(ks[17], (DEPTH, DIFF_W, D_MODEL), DIFF_W ** -0.5),
        'w_out': nrm(ks[18], (DEPTH, D_MODEL, D_MODEL), D_MODEL ** -0.5),
        'norm2_g': 1.0 + nrm(ks[19], (DEPTH, D_MODEL), 0.05),
        'w_up': nrm(ks[20], (DEPTH, D_MODEL, 2 * D_FF), D_MODEL ** -0.5),
        'conv_w': nrm(ks[21], (DEPTH, CONV_W, 2 * D_FF), CONV_W ** -0.5),
        'conv_b': nrm(ks[22], (DEPTH, 2 * D_FF), 0.02),
        'w_down': nrm(ks[23], (DEPTH, D_FF, D_MODEL), D_FF ** -0.5),
    }


def reference(x_prompt, x_sample, cache_k, cache_v, state_ret, state_conv, norm1_g, w_in, ret_norm_g,
              q_norm_g, k_norm_g, lambda_q1, lambda_k1, lambda_q2, lambda_k2, diff_norm_g, w_branch_a,
              w_branch_b, w_out, norm2_g, w_up, conv_w, conv_b, w_down):
    past = cache_k.shape[2]
    pos_p = jnp.arange(x_prompt.shape[1], dtype=jnp.int32)
    pos_s = past + jnp.arange(x_sample.shape[1], dtype=jnp.int32)
    yp, ys = x_prompt, x_sample
    kp_l, vp_l, sp_l, cp_l = [], [], [], []
    ks_l, vs_l, ss_l, cs_l = [], [], [], []
    for l in range(DEPTH):
        p = {
            'norm1_g': norm1_g[l], 'w_in': w_in[l], 'ret_norm_g': ret_norm_g[l],
            'q_norm_g': q_norm_g[l], 'k_norm_g': k_norm_g[l],
            'lambda_q1': lambda_q1[l], 'lambda_k1': lambda_k1[l],
            'lambda_q2': lambda_q2[l], 'lambda_k2': lambda_k2[l],
            'diff_norm_g': diff_norm_g[l], 'w_branch_a': w_branch_a[l], 'w_branch_b': w_branch_b[l],
            'w_out': w_out[l], 'norm2_g': norm2_g[l], 'w_up': w_up[l], 'conv_w': conv_w[l],
            'conv_b': conv_b[l], 'w_down': w_down[l],
        }
        lam_init = 0.8 - 0.6 * math.exp(-0.3 * l)
        yp, (kp, vp, sp, cp) = layer_prompt(yp, pos_p, p, lam_init)
        ys, (kn, vn, sn, cn) = layer_sample(ys, pos_s, cache_k[l], cache_v[l], state_ret[l], state_conv[l], p, lam_init)
        kp_l.append(kp); vp_l.append(vp); sp_l.append(sp); cp_l.append(cp)
        ks_l.append(kn); vs_l.append(vn); ss_l.append(sn); cs_l.append(cn)
    return (yp, ys, jnp.stack(kp_l), jnp.stack(vp_l), jnp.stack(sp_l), jnp.stack(cp_l),
            jnp.stack(ks_l), jnp.stack(vs_l), jnp.stack(ss_l), jnp.stack(cs_l))
```

```cpp
#include <hip/hip_runtime.h>
#include <hip/hip_cooperative_groups.h>
#include <cstdio>
#include <cstdint>
namespace cg = cooperative_groups;

#define LAS __attribute__((address_space(3)))
typedef unsigned short bf16_t;
typedef short bf16x8 __attribute__((ext_vector_type(8)));
typedef short s16x4 __attribute__((ext_vector_type(4)));
typedef float f32x2 __attribute__((ext_vector_type(2)));
typedef float f32x4 __attribute__((ext_vector_type(4)));
typedef float f32x16 __attribute__((ext_vector_type(16)));
typedef unsigned u32x2 __attribute__((ext_vector_type(2)));
typedef unsigned u32x4 __attribute__((ext_vector_type(4)));
typedef __bf16 bf16x2_t __attribute__((ext_vector_type(2)));

constexpr int DM = 1024, NB = 32, T = 2048, NSB = 8, LS = 32, PAST = 2048;
constexpr int MP = NB * T, MS = NSB * LS, M = MP + MS;
constexpr int INW = 8192, FF = 2816, FF2 = 5632;
constexpr int NPOS = PAST + LS;
constexpr float EPS = 1e-6f;
constexpr float LOG2E = 1.4426950408889634f;
constexpr float C2 = 0.125f * LOG2E;

constexpr size_t al256(size_t x) { return (x + 255) & ~(size_t)255; }
constexpr size_t WS_CTL = 0, CTL_BYTES = 4096;
constexpr size_t WS_RT = 65536;
constexpr size_t WS_DT = al256(WS_RT + (size_t)NPOS * 64 * 8);
constexpr size_t WS_STAT = al256(WS_DT + (size_t)NPOS * 8 * 8);
constexpr size_t WS_W = al256(WS_STAT + (size_t)M * 16 * 4);
constexpr size_t W_IN = 0, W_AB = W_IN + (size_t)INW * DM * 2, W_O = W_AB + (size_t)2048 * DM * 2, W_UP = W_O + (size_t)DM * DM * 2,
                 W_DN = W_UP + (size_t)FF2 * DM * 2, W_LAYER = W_DN + (size_t)DM * FF * 2;
constexpr size_t WS_CK = al256(WS_W + 2 * W_LAYER);
constexpr size_t CACHE_L = (size_t)NSB * PAST * 1024 * 2;
constexpr size_t WS_CV = WS_CK + 2 * CACHE_L;
constexpr size_t WS_XB = WS_CV + 2 * CACHE_L;
constexpr size_t R1K = (size_t)M * 1024 * 2;
constexpr size_t WS_P1 = WS_XB + R1K;
constexpr size_t P_QR = WS_P1, P_KR = P_QR + R1K / 2, P_VR = P_KR + R1K / 2, P_RD = P_VR + R1K, P_KD = P_RD + 2 * R1K, P_VD = P_KD + R1K,
                 P_GA = P_VD + R1K, P_GB = P_GA + R1K, WS_END = P_GB + R1K;
constexpr size_t P_YP = P_KD;
constexpr size_t P_Y = P_VR;
constexpr size_t P_Z = WS_P1;
constexpr size_t P_U = al256(P_Z + (size_t)M * FF * 2);
constexpr size_t WS_END2 = P_U + (size_t)M * FF2 * 2 > WS_END ? P_U + (size_t)M * FF2 * 2 : WS_END;
static_assert(P_Z + (size_t)M * FF * 2 <= P_KD, "z overlay");

__device__ __forceinline__ unsigned pk2(float lo, float hi) { f32x2 v = {lo, hi}; bf16x2_t b = __builtin_convertvector(v, bf16x2_t); return __builtin_bit_cast(unsigned, b); }
__device__ __forceinline__ float bflo(unsigned u) { return __builtin_bit_cast(float, u << 16); }
__device__ __forceinline__ float bfhi(unsigned u) { return __builtin_bit_cast(float, u & 0xffff0000u); }
__device__ __forceinline__ u32x4 pk8(const float* v) { u32x4 w; w.x = pk2(v[0], v[1]); w.y = pk2(v[2], v[3]); w.z = pk2(v[4], v[5]); w.w = pk2(v[6], v[7]); return w; }
__device__ __forceinline__ void unpk8(u32x4 w, float* v) { v[0] = bflo(w.x); v[1] = bfhi(w.x); v[2] = bflo(w.y); v[3] = bfhi(w.y); v[4] = bflo(w.z); v[5] = bfhi(w.z); v[6] = bflo(w.w); v[7] = bfhi(w.w); }
__device__ __forceinline__ float fast_exp2(float x) { return __builtin_amdgcn_exp2f(x); }
__device__ __forceinline__ float fast_rcp(float x) { return __builtin_amdgcn_rcpf(x); }
__device__ __forceinline__ float sigmoidf_(float x) { return fast_rcp(1.f + fast_exp2(-x * LOG2E)); }
__device__ __forceinline__ float wave_sum(float v) {
#pragma unroll
    for (int o = 1; o < 64; o <<= 1) v += __shfl_xor(v, o);
    return v;
}
__device__ __forceinline__ float wave_max(float v) {
#pragma unroll
    for (int o = 1; o < 64; o <<= 1) v = fmaxf(v, __shfl_xor(v, o));
    return v;
}
#define LAUNDER(x) asm volatile("" : "+v"(x))
__device__ __forceinline__ int crow(int r, int hi) { return (r & 3) + 8 * (r >> 2) + 4 * hi; }
__device__ __forceinline__ int swz(int row, int ch) { return 256 * row + 16 * (ch ^ (((row & 3) << 2) | ((row >> 2) & 3))); }
__device__ __forceinline__ int swzv(int row, int ch) { return 512 * row + 16 * (ch ^ (((row & 3) << 2) | ((row >> 2) & 3))); }
__device__ __forceinline__ int swza(int row, int ch) { return 128 * row + 16 * (ch ^ (row & 7)); }
__device__ __forceinline__ s16x4 ldtr(const LAS unsigned char* p) { return __builtin_bit_cast(s16x4, __builtin_amdgcn_ds_read_tr16_b64_v4i16((LAS s16x4*)p)); }
__device__ __forceinline__ bf16x8 cat4(s16x4 lo, s16x4 hi) { return (bf16x8){lo[0], lo[1], lo[2], lo[3], hi[0], hi[1], hi[2], hi[3]}; }

namespace pg8 {
constexpr int BM = 256, BK = 64, HALF = 128, HTB = HALF * BK * 2, NXCD = 8, WGM = 8;
__host__ __device__ __forceinline__ int lds_byte(int r, int c) { const int st = (r >> 4) * 2 + (c >> 5), rr = r & 15, cc = c & 31, ob = rr * 64 + cc * 2; return st * 1024 + (ob ^ (((ob >> 9) & 1) << 5)); }
__host__ __device__ __forceinline__ void stage_rc(int b, int& R, int& C) { const int st = b / 1024, sb = b % 1024, swz_ = sb ^ (((sb >> 9) & 1) << 5); R = (st >> 1) * 16 + swz_ / 64; C = (st & 1) * 32 + (swz_ % 64) / 2; }
__host__ __device__ __forceinline__ int perm32(int rho) { const int n = rho >> 4, i = rho & 15; return 8 * (i >> 2) + 4 * n + (i & 3); }

struct Unit { int pm, pn, aoff; };
struct Gemm { const bf16_t* A; const bf16_t* Bt; int nM, nN, K, lda; };

struct Order {
    int nM, nN, nwg, G, c, dup;
    __device__ void init(int nM_, int nN_, int G_, int c_, int dup_) { nM = nM_; nN = nN_; nwg = nM * nN; G = G_; c = c_; dup = dup_; }
    __device__ bool next(int i, Unit& u) const {
        const int j = i / dup, br = i - j * dup;
        const long L = (long)j * G + c; if (L >= nwg) return false;
        int wgid = (int)L; { const int q = nwg / NXCD, r = nwg % NXCD, xcd = wgid % NXCD, off = wgid / NXCD; wgid = (xcd < r ? xcd * (q + 1) : r * (q + 1) + (xcd - r) * q) + off; }
        const int nig = WGM * nN, gid = wgid / nig, fm = gid * WGM, gsz = (nM - fm) < WGM ? (nM - fm) : WGM;
        u.pm = fm + ((wgid % nig) % gsz); u.pn = (wgid % nig) / gsz + br * nN; u.aoff = br * 1024; return true;
    }
};

template <class Epi>
__device__ __forceinline__ void gemm_phase(LAS unsigned char* lds, const Gemm g, const Order& S, const Epi& E) {
    int tid = threadIdx.x; LAUNDER(tid);
    const int wid = __builtin_amdgcn_readfirstlane(tid >> 6), lane = tid & 63, wr = wid >> 2, wc = wid & 3, fr = lane & 15, fq = lane >> 4;
    const int K = g.K, nt = K / BK, lda = g.lda;
    unsigned voffA[2], voffB[2];
#pragma unroll
    for (int i = 0; i < 2; ++i) { int R, C; stage_rc(tid * 16 + i * 8192, R, C); const int Rb = (R & ~31) + perm32(R & 31);
        voffA[i] = (unsigned)(R * lda + C) * 2u; voffB[i] = (unsigned)(Rb * K + C) * 2u; }
    const size_t kstep = (size_t)(BK * 2);
    const size_t hstepA = (size_t)HALF * lda * 2, hstepB = (size_t)HALF * K * 2;
    const size_t tstepA = 2 * hstepA, tstepB = 2 * hstepB;
    const unsigned ldsw = (unsigned)wid * 1024u;
    const int aoff = lds_byte(wr * 64 + fr, fq * 8), boff = lds_byte(wc * 32 + fr, fq * 8);
#define PG8_SA(b, h) (((b) * 2 + (h)) * HTB)
#define PG8_SB(b, h) ((4 + (b) * 2 + (h)) * HTB)
#define PG8_STAGE(bufoff, gbase, voff) do { _Pragma("unroll") for (int _i = 0; _i < 2; ++_i) \
        __builtin_amdgcn_global_load_lds((const unsigned*)((const char*)(gbase) + (voff)[_i]), (LAS unsigned*)(lds + (bufoff) + ldsw + _i * 8192), 16, 0, 0); } while (0)
#define PG8_LDA(dst, b, h) do { _Pragma("unroll") for (int m = 0; m < 4; ++m) _Pragma("unroll") for (int k = 0; k < 2; ++k) dst[m][k] = *(const LAS bf16x8*)(lds + PG8_SA(b, h) + aoff + m * 2048 + k * 1024); } while (0)
#define PG8_LDB(dst, b, h) do { _Pragma("unroll") for (int n = 0; n < 2; ++n) _Pragma("unroll") for (int k = 0; k < 2; ++k) dst[n][k] = *(const LAS bf16x8*)(lds + PG8_SB(b, h) + boff + n * 2048 + k * 1024); } while (0)
#define PG8_MMA(ai, bj, At, Bt) do { __builtin_amdgcn_s_setprio(1); _Pragma("unroll") for (int m = 0; m < 4; ++m) _Pragma("unroll") for (int n = 0; n < 2; ++n) _Pragma("unroll") for (int k = 0; k < 2; ++k) \
        acc[ai][bj][m][n] = __builtin_amdgcn_mfma_f32_16x16x32_bf16(Bt[n][k], At[m][k], acc[ai][bj][m][n], 0, 0, 0); __builtin_amdgcn_s_setprio(0); } while (0)
#define PG8_WAIT_V(n) asm volatile("s_waitcnt vmcnt(" #n ")" ::: "memory")
#define PG8_WAIT_L(n) asm volatile("s_waitcnt lgkmcnt(" #n ")" ::: "memory")
#define PG8_BAR __builtin_amdgcn_s_barrier()
#define PG8_SCHED __builtin_amdgcn_sched_barrier(0)
    Unit cur, nxt; int ui = 0;
    if (!S.next(0, cur)) return;
    f32x4 acc[2][2][4][2];
#pragma unroll
    for (int a = 0; a < 2; ++a)
#pragma unroll
        for (int b = 0; b < 2; ++b)
#pragma unroll
            for (int m = 0; m < 4; ++m)
#pragma unroll
                for (int n = 0; n < 2; ++n) acc[a][b][m][n] = (f32x4){0.f, 0.f, 0.f, 0.f};
    bf16x8 At[4][2], B0[2][2], B1[2][2];
    const char* cA = (const char*)g.A + (size_t)cur.pm * tstepA + (size_t)cur.aoff * 2; const char* cB = (const char*)g.Bt + (size_t)cur.pn * tstepB;
    PG8_STAGE(PG8_SB(0, 0), cB, voffB); PG8_STAGE(PG8_SB(0, 1), cB + hstepB, voffB); PG8_STAGE(PG8_SA(0, 0), cA, voffA); PG8_STAGE(PG8_SA(0, 1), cA + hstepA, voffA);
    if (wr == 1) PG8_BAR;
    PG8_WAIT_V(2); PG8_BAR;
    PG8_STAGE(PG8_SB(1, 0), cB + kstep, voffB); PG8_STAGE(PG8_SA(1, 0), cA + kstep, voffA); PG8_STAGE(PG8_SB(1, 1), cB + hstepB + kstep, voffB);
    PG8_WAIT_V(6); PG8_BAR;
    for (;;) {
        const bool has_next = S.next(ui + 1, nxt);
        const char* nA = has_next ? (const char*)g.A + (size_t)nxt.pm * tstepA + (size_t)nxt.aoff * 2 : cA; const char* nB = has_next ? (const char*)g.Bt + (size_t)nxt.pn * tstepB : cB;
        for (int t = 0; t < nt; t += 2) {
            const bool last = (t == nt - 2);
            const char* a1 = cA + (size_t)(t + 1) * kstep;
            const char* a2 = last ? nA : cA + (size_t)(t + 2) * kstep; const char* b2 = last ? nB : cB + (size_t)(t + 2) * kstep;
            const char* a3 = a2 + kstep; const char* b3 = b2 + kstep;
            PG8_LDB(B0, 0, 0); PG8_LDB(B1, 0, 1); PG8_SCHED; PG8_LDA(At, 0, 0); PG8_STAGE(PG8_SA(1, 1), a1 + hstepA, voffA);
            PG8_WAIT_V(8); PG8_WAIT_L(0); PG8_BAR; PG8_MMA(0, 0, At, B0); PG8_MMA(0, 1, At, B1); PG8_BAR; PG8_SCHED;
            PG8_LDA(At, 0, 1); PG8_STAGE(PG8_SB(0, 0), b2, voffB); PG8_STAGE(PG8_SB(0, 1), b2 + hstepB, voffB); PG8_STAGE(PG8_SA(0, 0), a2, voffA);
            PG8_WAIT_V(8); PG8_WAIT_L(0); PG8_BAR; PG8_MMA(1, 0, At, B0); PG8_MMA(1, 1, At, B1); PG8_BAR; PG8_SCHED;
            PG8_LDB(B0, 1, 0); PG8_LDB(B1, 1, 1); PG8_SCHED; PG8_LDA(At, 1, 0); PG8_STAGE(PG8_SA(0, 1), a2 + hstepA, voffA);
            PG8_WAIT_V(8); PG8_WAIT_L(0); PG8_BAR; PG8_MMA(0, 0, At, B0); PG8_MMA(0, 1, At, B1); PG8_BAR; PG8_SCHED;
            PG8_LDA(At, 1, 1); PG8_STAGE(PG8_SB(1, 0), b3, voffB); PG8_STAGE(PG8_SB(1, 1), b3 + hstepB, voffB); PG8_STAGE(PG8_SA(1, 0), a3, voffA);
            PG8_WAIT_V(8); PG8_WAIT_L(0); PG8_BAR; PG8_MMA(1, 0, At, B0); PG8_MMA(1, 1, At, B1); PG8_BAR; PG8_SCHED;
        }
        if (wr == 0) PG8_BAR;
        E(acc, cur, wr, wc, fr, fq);
        if (!has_next) break;
#pragma unroll
        for (int a = 0; a < 2; ++a)
#pragma unroll
            for (int b = 0; b < 2; ++b)
#pragma unroll
                for (int m = 0; m < 4; ++m)
#pragma unroll
                    for (int n = 0; n < 2; ++n) acc[a][b][m][n] = (f32x4){0.f, 0.f, 0.f, 0.f};
        cur = nxt; cA = nA; cB = nB; ++ui;
        if (wr == 1) PG8_BAR;
    }
    PG8_WAIT_V(0);
    PG8_BAR;
#undef PG8_SA
#undef PG8_SB
#undef PG8_STAGE
#undef PG8_LDA
#undef PG8_LDB
#undef PG8_MMA
#undef PG8_WAIT_V
#undef PG8_WAIT_L
#undef PG8_BAR
#undef PG8_SCHED
}
}
using pg8::Unit;
typedef const f32x4 (&AccRef)[2][2][4][2];
#define ACC8(dst, ai, bj, m, s) do { dst[0] = acc[ai][bj][m][0][0] * (s); dst[1] = acc[ai][bj][m][0][1] * (s); dst[2] = acc[ai][bj][m][0][2] * (s); dst[3] = acc[ai][bj][m][0][3] * (s); \
    dst[4] = acc[ai][bj][m][1][0] * (s); dst[5] = acc[ai][bj][m][1][1] * (s); dst[6] = acc[ai][bj][m][1][2] * (s); dst[7] = acc[ai][bj][m][1][3] * (s); } while (0)

__device__ __forceinline__ float row_rstd(const float* stat, int row) {
    const f32x4* p = (const f32x4*)(stat + (size_t)row * 16);
    const f32x4 a = p[0], b = p[1], c = p[2], d = p[3];
    const float s = ((a.x + a.y) + (a.z + a.w)) + ((b.x + b.y) + (b.z + b.w)) + ((c.x + c.y) + (c.z + c.w)) + ((d.x + d.y) + (d.z + d.w));
    return rsqrtf(s * (1.f / 1024.f) + EPS);
}
__device__ __forceinline__ int row_pos(int row) { return row < MP ? (row & (T - 1)) : PAST + ((row - MP) & (LS - 1)); }

struct EpiIn {
    const float* stat;
    bf16_t *QR, *KR, *VR, *RD, *KD, *VD, *GA, *GB;
    float *kout_p, *vout_p, *kout_s, *vout_s;
    const f32x2* RT; const f32x2* DT;
    const float *qng, *kng;
    __device__ __forceinline__ void operator()(AccRef acc, const Unit& u, int wr, int wc, int fr, int fq) const {
        const int pn = u.pn, rowb = u.pm * 256 + wr * 64 + fr;
        if (pn < 4) {
            const bool isk = pn >= 2; const int head = (pn & 1) * 2 + (wc >> 1), i0 = 32 * (wc & 1) + 8 * fq;
            bf16_t* dst = (isk ? KR : QR) + head * 128 + i0; const float sc = isk ? 0.08838834764831845f : 1.f;
#pragma unroll
            for (int ai = 0; ai < 2; ++ai)
#pragma unroll
                for (int m = 0; m < 4; ++m) {
                    const int row = rowb + ai * 128 + m * 16; const float rs = row_rstd(stat, row) * sc;
                    float x1[8], x2[8], o1[8], o2[8]; ACC8(x1, ai, 0, m, rs); ACC8(x2, ai, 1, m, rs);
                    const f32x4* cs = (const f32x4*)(RT + (size_t)row_pos(row) * 64 + i0);
#pragma unroll
                    for (int e2 = 0; e2 < 4; ++e2) { const f32x4 t = cs[e2];
                        o1[2 * e2] = x1[2 * e2] * t.x - x2[2 * e2] * t.y; o2[2 * e2] = x2[2 * e2] * t.x + x1[2 * e2] * t.y;
                        o1[2 * e2 + 1] = x1[2 * e2 + 1] * t.z - x2[2 * e2 + 1] * t.w; o2[2 * e2 + 1] = x2[2 * e2 + 1] * t.z + x1[2 * e2 + 1] * t.w; }
                    *(u32x4*)(dst + (size_t)row * 512) = pk8(o1); *(u32x4*)(dst + (size_t)row * 512 + 64) = pk8(o2);
                }
        } else if (pn >= 12 && pn < 20) {
            const bool isk = pn >= 16; const int G = (pn - (isk ? 16 : 12)) * 4 + wc, head = G >> 1, map = G & 1, d0 = 16 * fq;
            const float* gg = isk ? kng : qng; float g0[8], g1[8];
#pragma unroll
            for (int e = 0; e < 8; ++e) { g0[e] = gg[d0 + e]; g1[e] = gg[d0 + 8 + e]; }
            const int cb = head * 128 + map * 64 + d0;
#pragma unroll
            for (int ai = 0; ai < 2; ++ai)
#pragma unroll
                for (int m = 0; m < 4; ++m) {
                    const int row = rowb + ai * 128 + m * 16; const float rs = row_rstd(stat, row);
                    float x0[8], x1[8]; ACC8(x0, ai, 0, m, rs); ACC8(x1, ai, 1, m, rs);
                    float ss = 0.f;
#pragma unroll
                    for (int e = 0; e < 8; ++e) ss += x0[e] * x0[e] + x1[e] * x1[e];
                    ss += __shfl_xor(ss, 16); ss += __shfl_xor(ss, 32);
                    const float r = rsqrtf(ss * (1.f / 64.f) + EPS);
#pragma unroll
                    for (int e = 0; e < 8; ++e) { x0[e] *= r * g0[e]; x1[e] *= r * g1[e]; }
                    const f32x4* cs = (const f32x4*)(DT + (size_t)row_pos(row) * 8);
                    const bool rot = (fq == 0);
#pragma unroll
                    for (int e2 = 0; e2 < 4; ++e2) { const f32x4 t = cs[e2];
                        const float a0 = x0[2 * e2], b0 = x1[2 * e2], a1 = x0[2 * e2 + 1], b1 = x1[2 * e2 + 1];
                        const float ra0 = a0 * t.x - b0 * t.y, rb0 = b0 * t.x + a0 * t.y, ra1 = a1 * t.z - b1 * t.w, rb1 = b1 * t.z + a1 * t.w;
                        x0[2 * e2] = rot ? ra0 : a0; x1[2 * e2] = rot ? rb0 : b0; x0[2 * e2 + 1] = rot ? ra1 : a1; x1[2 * e2 + 1] = rot ? rb1 : b1; }
                    if (isk) {
                        float* ko = (row < MP ? kout_p + (size_t)row * 1024 : kout_s + (size_t)(row - MP) * 1024) + cb;
                        *(f32x4*)(ko) = (f32x4){x0[0], x0[1], x0[2], x0[3]}; *(f32x4*)(ko + 4) = (f32x4){x0[4], x0[5], x0[6], x0[7]};
                        *(f32x4*)(ko + 8) = (f32x4){x1[0], x1[1], x1[2], x1[3]}; *(f32x4*)(ko + 12) = (f32x4){x1[4], x1[5], x1[6], x1[7]};
                        bf16_t* d = KD + (size_t)row * 1024 + cb; *(u32x4*)d = pk8(x0); *(u32x4*)(d + 8) = pk8(x1);
                    } else {
#pragma unroll
                        for (int e = 0; e < 8; ++e) { x0[e] *= C2; x1[e] *= C2; }
                        bf16_t* d = RD + (size_t)row * 2048 + 1024 + cb; *(u32x4*)d = pk8(x0); *(u32x4*)(d + 8) = pk8(x1);
                    }
                }
        } else {
            const int kind = pn >> 2;
            const int cl = (pn & 3) * 256 + 32 * wc + 8 * fq;
            bf16_t* base; size_t pitch = 1024;
            if (kind == 1) base = VR; else if (kind == 2) { base = RD; pitch = 2048; } else if (kind == 5) base = VD; else if (kind == 6) base = GA; else base = GB;
#pragma unroll
            for (int ai = 0; ai < 2; ++ai)
#pragma unroll
                for (int m = 0; m < 4; ++m) {
                    const int row = rowb + ai * 128 + m * 16; const float rs = row_rstd(stat, row);
#pragma unroll
                    for (int bj = 0; bj < 2; ++bj) {
                        float x[8]; ACC8(x, ai, bj, m, rs);
                        if (kind == 2) {
#pragma unroll
                            for (int e = 0; e < 8; ++e) x[e] = x[e] * sigmoidf_(x[e]);
                        } else if (kind >= 6) {
#pragma unroll
                            for (int e = 0; e < 8; ++e) x[e] = sigmoidf_(x[e]);
                        } else if (kind == 5) {
                            float* vo = (row < MP ? vout_p + (size_t)row * 1024 : vout_s + (size_t)(row - MP) * 1024) + cl + bj * 128;
                            *(f32x4*)(vo) = (f32x4){x[0], x[1], x[2], x[3]}; *(f32x4*)(vo + 4) = (f32x4){x[4], x[5], x[6], x[7]};
                        }
                        *(u32x4*)(base + (size_t)row * pitch + cl + bj * 128) = pk8(x);
                    }
                }
        }
    }
};

struct EpiBranch {
    const bf16_t *GA, *GB; float* YP; bf16_t* Y;
    __device__ __forceinline__ void operator()(AccRef acc, const Unit& u, int wr, int wc, int fr, int fq) const {
        const int br = u.pn >> 2, rowb = u.pm * 256 + wr * 64 + fr, cl = (u.pn & 3) * 256 + 32 * wc + 8 * fq;
        const bf16_t* gsrc = br ? GB : GA;
#pragma unroll
        for (int ai = 0; ai < 2; ++ai)
#pragma unroll
            for (int m = 0; m < 4; ++m) {
                const int row = rowb + ai * 128 + m * 16;
#pragma unroll
                for (int bj = 0; bj < 2; ++bj) {
                    const size_t o = (size_t)row * 1024 + cl + bj * 128;
                    float x[8], gt[8]; ACC8(x, ai, bj, m, 1.f); unpk8(*(const u32x4*)(gsrc + o), gt);
                    if (br == 0) {
                        *(f32x4*)(YP + o) = (f32x4){x[0] * gt[0], x[1] * gt[1], x[2] * gt[2], x[3] * gt[3]};
                        *(f32x4*)(YP + o + 4) = (f32x4){x[4] * gt[4], x[5] * gt[5], x[6] * gt[6], x[7] * gt[7]};
                    } else {
                        const f32x4 p0 = *(const f32x4*)(YP + o), p1 = *(const f32x4*)(YP + o + 4);
                        float y[8] = {p0.x + x[0] * gt[0], p0.y + x[1] * gt[1], p0.z + x[2] * gt[2], p0.w + x[3] * gt[3],
                                      p1.x + x[4] * gt[4], p1.y + x[5] * gt[5], p1.z + x[6] * gt[6], p1.w + x[7] * gt[7]};
                        *(u32x4*)(Y + o) = pk8(y);
                    }
                }
            }
    }
};

struct EpiRes {
    const float *xin_p, *xin_s; float *xo_p, *xo_s; bf16_t* XB; float* stat; int write_next;
    __device__ __forceinline__ void operator()(AccRef acc, const Unit& u, int wr, int wc, int fr, int fq) const {
        const int rowb = u.pm * 256 + wr * 64 + fr, cl = u.pn * 256 + 32 * wc + 8 * fq;
#pragma unroll
        for (int ai = 0; ai < 2; ++ai)
#pragma unroll
            for (int m = 0; m < 4; ++m) {
                const int row = rowb + ai * 128 + m * 16;
                const float* xi = row < MP ? xin_p + (size_t)row * 1024 : xin_s + (size_t)(row - MP) * 1024;
                float* xo = row < MP ? xo_p + (size_t)row * 1024 : xo_s + (size_t)(row - MP) * 1024;
                float ss = 0.f;
#pragma unroll
                for (int bj = 0; bj < 2; ++bj) {
                    const int c = cl + bj * 128;
                    float x[8]; ACC8(x, ai, bj, m, 1.f);
                    const f32x4 p0 = *(const f32x4*)(xi + c), p1 = *(const f32x4*)(xi + c + 4);
                    x[0] += p0.x; x[1] += p0.y; x[2] += p0.z; x[3] += p0.w; x[4] += p1.x; x[5] += p1.y; x[6] += p1.z; x[7] += p1.w;
                    *(f32x4*)(xo + c) = (f32x4){x[0], x[1], x[2], x[3]}; *(f32x4*)(xo + c + 4) = (f32x4){x[4], x[5], x[6], x[7]};
                    if (write_next) {
                        *(u32x4*)(XB + (size_t)row * 1024 + c) = pk8(x);
#pragma unroll
                        for (int e = 0; e < 8; ++e) ss += x[e] * x[e];
                    }
                }
                if (write_next) {
                    ss += __shfl_xor(ss, 16); ss += __shfl_xor(ss, 32);
                    if (fq == 0) stat[(size_t)row * 16 + u.pn * 4 + wc] = ss;
                }
            }
    }
};

template <int CTRL> __device__ __forceinline__ float dppf(float old, float src) {
    return __builtin_bit_cast(float, __builtin_amdgcn_update_dpp(__builtin_bit_cast(int, old), __builtin_bit_cast(int, src), CTRL, 0xf, 0xf, false));
}
struct EpiUp {
    const float* stat; bf16_t* U;
    __device__ __forceinline__ void operator()(AccRef acc, const Unit& u, int wr, int wc, int fr, int fq) const {
        const int rowb = u.pm * 256 + wr * 64 + fr, ca = u.pn * 128 + 32 * wc + 8 * fq;
#pragma unroll
        for (int ai = 0; ai < 2; ++ai)
#pragma unroll
            for (int m = 0; m < 4; ++m) {
                const int row = rowb + ai * 128 + m * 16; const float rs = row_rstd(stat, row);
#pragma unroll
                for (int bj = 0; bj < 2; ++bj) { float x[8]; ACC8(x, ai, bj, m, rs); *(u32x4*)(U + (size_t)row * FF2 + ca + bj * FF) = pk8(x); }
            }
    }
};

struct Args {
    const float* in[24]; float* out; unsigned char* ws; int ph_lo, ph_hi;
};
constexpr size_t O_YP = 0, O_YS = O_YP + (size_t)MP * 1024, O_KP = O_YS + (size_t)MS * 1024, O_VP = O_KP + 2 * (size_t)MP * 1024, O_SRP = O_VP + 2 * (size_t)MP * 1024,
                 O_SCP = O_SRP + (size_t)2 * NB * 4 * 128 * 256, O_KS = O_SCP + (size_t)2 * NB * 2 * FF2, O_VS = O_KS + 2 * (size_t)MS * 1024, O_SRS = O_VS + 2 * (size_t)MS * 1024,
                 O_SCS = O_SRS + (size_t)2 * NSB * 4 * 128 * 256, O_END = O_SCS + (size_t)2 * NSB * 2 * FF2;
enum { I_XP = 0, I_XS, I_CK, I_CV, I_SR, I_SC, I_N1, I_WIN, I_RNG, I_QNG, I_KNG, I_LQ1, I_LK1, I_LQ2, I_LK2, I_DNG, I_WA, I_WB, I_WO, I_N2, I_WUP, I_CW, I_CB, I_WDN };

template <int MODE>
__device__ __forceinline__ int phys_col(int c) {
    if (MODE == 1) {
        if (c < 1024) { const int t = c >> 8, cl = c & 255, hl = cl >> 7, half = (cl >> 6) & 1, i = cl & 63; return t * 256 + 128 * half + 64 * hl + i; }
        if (c >= 3072 && c < 5120) { const int t = c >> 8, cl = c & 255, grp = cl >> 6, d = cl & 63, fq = d >> 4, bj = (d >> 3) & 1, e = d & 7; return t * 256 + 128 * bj + 32 * grp + 8 * fq + e; }
        return c;
    } else if (MODE == 2) {
        if (c < FF) return 256 * (c >> 7) + (c & 127);
        const int c2 = c - FF; return 256 * (c2 >> 7) + 128 + (c2 & 127);
    }
    return c;
}
template <int MODE>
__device__ __forceinline__ void transpose_item(const float* W, int K, int N, const float* kscale, bf16_t* WT, int row_off, LAS float* scr, int item, int lane) {
    const int nblk = N / 32, kb = item / nblk, nb = item % nblk, k0 = 64 * kb, n0 = 32 * nb;
#pragma unroll 8
    for (int i = 0; i < 32; ++i) { const int kk = 2 * i + (lane >> 5); float v = W[(size_t)(k0 + kk) * N + n0 + (lane & 31)]; if (kscale) v *= kscale[k0 + kk]; scr[kk * 33 + (lane & 31)] = v; }
    asm volatile("s_waitcnt lgkmcnt(0)" ::: "memory");
    const int c = lane & 7;
#pragma unroll
    for (int j = 0; j < 4; ++j) { const int n = (lane >> 3) + 8 * j; const LAS float* s = scr + (8 * c) * 33 + n;
        u32x4 o; o.x = pk2(s[0 * 33], s[1 * 33]); o.y = pk2(s[2 * 33], s[3 * 33]); o.z = pk2(s[4 * 33], s[5 * 33]); o.w = pk2(s[6 * 33], s[7 * 33]);
        *(u32x4*)(WT + (size_t)(row_off + phys_col<MODE>(n0 + n)) * K + k0 + 8 * c) = o; }
    asm volatile("s_waitcnt lgkmcnt(0)" ::: "memory");
}

__device__ __forceinline__ void p0_prologue(const Args& a, LAS unsigned char* lds) {
    const int tid = threadIdx.x, lane = tid & 63, wave = tid >> 6;
    const int gw = blockIdx.x * 8 + wave, NGW = gridDim.x * 8;
    LAS float* scr = (LAS float*)(lds + wave * 16384);
    unsigned char* ws = a.ws;
    constexpr int I_IN = (DM / 64) * (INW / 32), I_SQ = (DM / 64) * (DM / 32), I_UP = (DM / 64) * (FF2 / 32), I_DN = (FF / 64) * (DM / 32);
    constexpr int PER_L = I_IN + 3 * I_SQ + I_UP + I_DN;
    for (int it = gw; it < 2 * PER_L; it += NGW) {
        const int l = it / PER_L; int r = it % PER_L;
        unsigned char* wl = ws + WS_W + (size_t)l * W_LAYER;
        if (r < I_IN) { transpose_item<1>(a.in[I_WIN] + (size_t)l * DM * INW, DM, INW, a.in[I_N1] + l * DM, (bf16_t*)(wl + W_IN), 0, scr, r, lane); continue; } r -= I_IN;
        if (r < I_SQ) { transpose_item<0>(a.in[I_WA] + (size_t)l * DM * DM, DM, DM, nullptr, (bf16_t*)(wl + W_AB), 0, scr, r, lane); continue; } r -= I_SQ;
        if (r < I_SQ) { transpose_item<0>(a.in[I_WB] + (size_t)l * DM * DM, DM, DM, nullptr, (bf16_t*)(wl + W_AB), 1024, scr, r, lane); continue; } r -= I_SQ;
        if (r < I_SQ) { transpose_item<0>(a.in[I_WO] + (size_t)l * DM * DM, DM, DM, nullptr, (bf16_t*)(wl + W_O), 0, scr, r, lane); continue; } r -= I_SQ;
        if (r < I_UP) { transpose_item<2>(a.in[I_WUP] + (size_t)l * DM * FF2, DM, FF2, a.in[I_N2] + l * DM, (bf16_t*)(wl + W_UP), 0, scr, r, lane); continue; } r -= I_UP;
        transpose_item<0>(a.in[I_WDN] + (size_t)l * FF * DM, FF, DM, nullptr, (bf16_t*)(wl + W_DN), 0, scr, r, lane);
    }
    bf16_t* XB = (bf16_t*)(ws + WS_XB); float* stat = (float*)(ws + WS_STAT);
    for (int m = gw; m < M; m += NGW) {
        const float* xr = m < MP ? a.in[I_XP] + (size_t)m * 1024 : a.in[I_XS] + (size_t)(m - MP) * 1024;
        float s = 0.f;
#pragma unroll
        for (int j = 0; j < 4; ++j) { const f32x4 v = *(const f32x4*)(xr + 256 * j + 4 * lane); s += (v.x * v.x + v.y * v.y) + (v.z * v.z + v.w * v.w);
            u32x2 o; o.x = pk2(v.x, v.y); o.y = pk2(v.z, v.w); *(u32x2*)(XB + (size_t)m * 1024 + 256 * j + 4 * lane) = o; }
        s = wave_sum(s);
        if (lane < 16) stat[(size_t)m * 16 + lane] = lane == 0 ? s : 0.f;
    }
    {
        const size_t n8 = (size_t)2 * NSB * PAST * 1024 / 8, gt = (size_t)blockIdx.x * 512 + tid, GT = (size_t)gridDim.x * 512;
        for (int w = 0; w < 2; ++w) {
            const float* src = a.in[w ? I_CV : I_CK]; bf16_t* dst = (bf16_t*)(ws + (w ? WS_CV : WS_CK));
            for (size_t i = gt; i < n8; i += GT) { const f32x4 v0 = *(const f32x4*)(src + i * 8), v1 = *(const f32x4*)(src + i * 8 + 4);
                u32x4 o; o.x = pk2(v0.x, v0.y); o.y = pk2(v0.z, v0.w); o.z = pk2(v1.x, v1.y); o.w = pk2(v1.z, v1.w); *(u32x4*)(dst + i * 8) = o; }
        }
    }
    {
        f32x2* RT = (f32x2*)(ws + WS_RT); f32x2* DT = (f32x2*)(ws + WS_DT);
        const int gt = blockIdx.x * 512 + tid, GT = gridDim.x * 512;
        for (int i = gt; i < NPOS * 72; i += GT) {
            const int pos = i / 72, k = i % 72;
            float inv;
            if (k < 64) inv = exp2f(-(float)k * (1.f / 64.f) * 13.287712379549449f);
            else inv = exp2f(-(float)(k - 64) * (1.f / 8.f) * 18.931568569324174f);
            const float ang = (float)pos * inv;
            const float rev = ang * 0.15915494309189535f, fr_ = rev - rintf(rev);
            const f32x2 cs = {__builtin_amdgcn_cosf(fr_), __builtin_amdgcn_sinf(fr_)};
            if (k < 64) RT[(size_t)pos * 64 + k] = cs; else DT[(size_t)pos * 8 + (k - 64)] = cs;
        }
    }
}

struct AttnP { bf16_t* RD; const bf16_t *KD, *VD, *CK, *CV; const float* dng; float lam, moff, oscale; };

__device__ __forceinline__ void attn_unit(LAS unsigned char* lds, const AttnP& P, int u) {
    int tid = threadIdx.x; LAUNDER(tid);
    const int lane = tid & 63, wave = __builtin_amdgcn_readfirstlane(tid >> 6), l31 = lane & 31, hh = lane >> 5;
    const int qblk = wave >> 1, map = wave & 1;
    bool sample; int h, qrow0, nt, sb = 0, ntw; size_t kvrow0;
    if (u < 64) { sample = true; sb = u >> 3; h = u & 7; qrow0 = MP + 32 * sb; nt = 33; ntw = (qblk == 0) ? 33 : 0; kvrow0 = 0; }
    else { const int v = u - 64, qb = 15 - (v >> 8), sh = v & 255, s = sh >> 3; sample = false; h = sh & 7; qrow0 = s * T + 128 * qb; nt = 2 * qb + 2; ntw = 2 * qb + 1 + (qblk >> 1); kvrow0 = (size_t)s * T; }
    const bool active = ntw > 0;
    const int lrow0 = tid >> 4, lch = tid & 15;
    u32x4 kreg0, kreg1, vreg0, vreg1;
    const size_t coff = (size_t)h * 128 + lch * 8;
    const bf16_t* k0 = sample ? P.CK + (size_t)sb * PAST * 1024 + coff : P.KD + kvrow0 * 1024 + coff;
    const bf16_t* v0 = sample ? P.CV + (size_t)sb * PAST * 1024 + coff : P.VD + kvrow0 * 1024 + coff;
    const size_t loff = ((size_t)MP + 32 * sb) * 1024 + coff;
#define GLOAD(j) do { \
        if (sample && (j) == 32) { \
            kreg0 = *(const u32x4*)(P.KD + loff + (size_t)lrow0 * 1024); vreg0 = *(const u32x4*)(P.VD + loff + (size_t)lrow0 * 1024); \
            kreg1 = (u32x4){0, 0, 0, 0}; vreg1 = (u32x4){0, 0, 0, 0}; \
        } else { \
            const size_t ro = ((size_t)64 * (j) + lrow0) * 1024; \
            kreg0 = *(const u32x4*)(k0 + ro); vreg0 = *(const u32x4*)(v0 + ro); kreg1 = *(const u32x4*)(k0 + ro + 32 * 1024); vreg1 = *(const u32x4*)(v0 + ro + 32 * 1024); \
        } } while (0)
#define LSTORE(buf) do { \
        *(LAS u32x4*)(lds + (buf) * 32768 + swz(lrow0, lch)) = kreg0; *(LAS u32x4*)(lds + (buf) * 32768 + 16384 + swz(lrow0, lch)) = vreg0; \
        *(LAS u32x4*)(lds + (buf) * 32768 + swz(lrow0 + 32, lch)) = kreg1; *(LAS u32x4*)(lds + (buf) * 32768 + 16384 + swz(lrow0 + 32, lch)) = vreg1; } while (0)
    GLOAD(0);
    bf16x8 qf[4];
    if (active) {
        const bf16_t* qp = P.RD + (size_t)(qrow0 + 32 * qblk + l31) * 2048 + 1024 + h * 128 + map * 64 + 8 * hh;
#pragma unroll
        for (int ks = 0; ks < 4; ++ks) qf[ks] = *(const bf16x8*)(qp + 16 * ks);
    } else {
#pragma unroll
        for (int ks = 0; ks < 4; ++ks) qf[ks] = (bf16x8){0, 0, 0, 0, 0, 0, 0, 0};
    }
    f32x16 O[4];
#pragma unroll
    for (int d = 0; d < 4; ++d)
#pragma unroll
        for (int r = 0; r < 16; ++r) O[d][r] = 0.f;
    float lsum = 0.f;
    const float nm = -P.moff;
    LSTORE(0);
    const int tq = (lane & 15) >> 2, tp = lane & 3, tblk = (lane >> 4) & 1;
    for (int j = 0; j < nt; ++j) {
        if (j + 1 < nt) GLOAD(j + 1);
        __syncthreads();
        if (j < ntw) {
            int lz = 0; LAUNDER(lz);
            const LAS unsigned char* Kb = lds + (j & 1) * 32768 + lz; const LAS unsigned char* Vb = Kb + 16384;
            const int nkb = (sample && j == 32) ? 1 : 2;
            f32x16 S0, S1;
#pragma unroll
            for (int r = 0; r < 16; ++r) { S0[r] = nm; S1[r] = nm; }
#pragma unroll
            for (int ks = 0; ks < 4; ++ks) {
                const bf16x8 a0 = *(const LAS bf16x8*)(Kb + swz(l31, map * 8 + 2 * ks + hh));
                S0 = __builtin_amdgcn_mfma_f32_32x32x16_bf16(a0, qf[ks], S0, 0, 0, 0);
                if (nkb == 2) { const bf16x8 a1 = *(const LAS bf16x8*)(Kb + swz(32 + l31, map * 8 + 2 * ks + hh));
                    S1 = __builtin_amdgcn_mfma_f32_32x32x16_bf16(a1, qf[ks], S1, 0, 0, 0); }
            }
            float ps = 0.f;
#pragma unroll
            for (int r = 0; r < 16; ++r) { S0[r] = fast_exp2(S0[r]); ps += S0[r]; }
            if (nkb == 2) {
#pragma unroll
                for (int r = 0; r < 16; ++r) { S1[r] = fast_exp2(S1[r]); ps += S1[r]; }
            }
            lsum += ps;
#pragma unroll
            for (int s = 0; s < 4; ++s) {
                if (s < 2 * nkb) {
                    u32x4 pw;
                    if (s == 0) pw = (u32x4){pk2(S0[0], S0[1]), pk2(S0[2], S0[3]), pk2(S0[4], S0[5]), pk2(S0[6], S0[7])};
                    else if (s == 1) pw = (u32x4){pk2(S0[8], S0[9]), pk2(S0[10], S0[11]), pk2(S0[12], S0[13]), pk2(S0[14], S0[15])};
                    else if (s == 2) pw = (u32x4){pk2(S1[0], S1[1]), pk2(S1[2], S1[3]), pk2(S1[4], S1[5]), pk2(S1[6], S1[7])};
                    else pw = (u32x4){pk2(S1[8], S1[9]), pk2(S1[10], S1[11]), pk2(S1[12], S1[13]), pk2(S1[14], S1[15])};
                    const bf16x8 pa = __builtin_bit_cast(bf16x8, pw);
                    const int r0 = 16 * s + 4 * hh + tq;
#pragma unroll
                    for (int dvb = 0; dvb < 4; ++dvb) {
                        const int ch = 4 * dvb + 2 * tblk + (tp >> 1);
                        const s16x4 lo = ldtr(Vb + swz(r0, ch) + 8 * (tp & 1)), hi = ldtr(Vb + swz(r0 + 8, ch) + 8 * (tp & 1));
                        O[dvb] = __builtin_amdgcn_mfma_f32_32x32x16_bf16(pa, cat4(lo, hi), O[dvb], 0, 0, 0);
                    }
                }
            }
        }
        if (j + 1 < nt) LSTORE((j + 1) & 1);
    }
    lsum += __shfl_xor(lsum, 32);
    LAS float* lx = (LAS float*)(lds + 131072 + 256);
    LAS float* comb = (LAS float*)lds;
    __syncthreads();
    if (hh == 0) lx[wave * 32 + l31] = fast_rcp(lsum);
    asm volatile("s_waitcnt lgkmcnt(0)" ::: "memory");
    float li[16];
#pragma unroll
    for (int r = 0; r < 16; ++r) li[r] = lx[wave * 32 + crow(r, hh)];
    if (map == 1 && active) {
#pragma unroll
        for (int d = 0; d < 4; ++d)
#pragma unroll
            for (int r = 0; r < 16; ++r) comb[(qblk * 32 + crow(r, hh)) * 128 + 32 * d + l31] = P.lam * O[d][r] * li[r];
    }
    __syncthreads();
    if (map == 0 && active) {
        float gg[4];
#pragma unroll
        for (int d = 0; d < 4; ++d) gg[d] = P.dng[32 * d + l31] * P.oscale;
#pragma unroll
        for (int r = 0; r < 16; ++r) {
            float v[4], ss = 0.f;
#pragma unroll
            for (int d = 0; d < 4; ++d) { v[d] = O[d][r] * li[r] - comb[(qblk * 32 + crow(r, hh)) * 128 + 32 * d + l31]; ss += v[d] * v[d]; }
            ss += __shfl_xor(ss, 1); ss += __shfl_xor(ss, 2); ss += __shfl_xor(ss, 4); ss += __shfl_xor(ss, 8); ss += __shfl_xor(ss, 16);
            const float rr = rsqrtf(ss * (1.f / 128.f) + EPS);
            bf16_t* op = P.RD + (size_t)(qrow0 + 32 * qblk + crow(r, hh)) * 2048 + 1024 + h * 128 + l31;
#pragma unroll
            for (int d = 0; d < 4; ++d) op[32 * d] = (bf16_t)(pk2(v[d] * rr * gg[d], 0.f) & 0xffffu);
        }
    }
    __syncthreads();
#undef GLOAD
#undef LSTORE
}

struct RetP { const bf16_t *QR, *KR, *VR; bf16_t* RD; const float* rng; const float* sr_in; float *sr_out_p, *sr_out_s; };
constexpr int R_Q = 0, R_K = 16384, R_KZ = 32768, R_V = 49152, R_A = 81920, R_O = 90112;

__device__ __forceinline__ void ret_unit(LAS unsigned char* lds, const RetP& P, int u) {
    int tid_o = threadIdx.x; LAUNDER(tid_o);
    const int lane_o = tid_o & 63, w = __builtin_amdgcn_readfirstlane(tid_o >> 6);
    int h, row0, nch, L; float* sout; const float* sin_ = nullptr;
    if (u < 128) { const int s = u >> 2; h = u & 3; row0 = s * T; nch = 32; L = 64; sout = P.sr_out_p + (size_t)(s * 4 + h) * 128 * 256; }
    else { const int b = (u - 128) >> 2; h = (u - 128) & 3; row0 = MP + 32 * b; nch = 1; L = 32; sout = P.sr_out_s + (size_t)(b * 4 + h) * 128 * 256; sin_ = P.sr_in + (size_t)(b * 4 + h) * 128 * 256; }
    const float lg = log2f(1.f - exp2f(-5.f - (float)h));
    const float glen = exp2f(lg * (float)L);
    f32x16 Sacc[4];
    { const int hh = lane_o >> 5, l31 = lane_o & 31;
#pragma unroll
    for (int db = 0; db < 4; ++db)
#pragma unroll
        for (int r = 0; r < 16; ++r) Sacc[db][r] = sin_ ? *(const float*)((const char*)sin_ + (unsigned)(((4 * hh * 256 + 32 * w + l31) + (32 * db + (r & 3) + 8 * (r >> 2)) * 256) * 4)) : 0.f;
    }
    for (int c = 0; c < nch; ++c) {
        const int crow0 = row0 + 64 * c;
        int ln_ = lane_o, td_ = tid_o; LAUNDER(ln_); LAUNDER(td_);
        const int tid = td_, l31 = ln_ & 31, hh = ln_ >> 5, l15 = ln_ & 15, g4 = ln_ >> 4, tq = (ln_ & 15) >> 2, tp = ln_ & 3, tblk = (ln_ >> 4) & 1;
        int lz = 0; LAUNDER(lz);
        float lgv = lg; LAUNDER(lgv);
        const LAS unsigned char* const ldr = lds;
        LAS unsigned char* const ldsS = lds + lz;
#pragma unroll
        for (int i = 0; i < 2; ++i) {
            const int cc = tid + 512 * i, row = cc >> 4, ch = cc & 15; const bool ok = row < L;
            u32x4 q = (u32x4){0, 0, 0, 0}, k = q;
            if (ok) { const size_t o = (size_t)(crow0 + row) * 512 + h * 128 + ch * 8; q = *(const u32x4*)(P.QR + o); k = *(const u32x4*)(P.KR + o); }
            float kf[8]; unpk8(k, kf); const float zt = exp2f(lgv * (float)(L - 1 - row));
#pragma unroll
            for (int e = 0; e < 8; ++e) kf[e] *= zt;
            *(LAS u32x4*)(ldsS + R_Q + swz(row, ch)) = q; *(LAS u32x4*)(ldsS + R_K + swz(row, ch)) = k; *(LAS u32x4*)(ldsS + R_KZ + swz(row, ch)) = pk8(kf);
        }
#pragma unroll
        for (int i = 0; i < 4; ++i) {
            const int cc = tid + 512 * i, row = cc >> 5, ch = cc & 31; const bool ok = row < L;
            u32x4 v = (u32x4){0, 0, 0, 0};
            if (ok) v = *(const u32x4*)(P.VR + (size_t)(crow0 + row) * 1024 + h * 256 + ch * 8);
            *(LAS u32x4*)(ldsS + R_V + swzv(row, ch)) = v;
        }
        __syncthreads();
        {
            const int ti = w >> 1; int l2 = 0; LAUNDER(l2); const LAS unsigned char* const ldA = ldr + l2;
#pragma unroll
            for (int tt = 0; tt < 2; ++tt) {
                const int tj = 2 * (w & 1) + tt;
                f32x4 sa = (f32x4){0.f, 0.f, 0.f, 0.f};
#pragma unroll
                for (int ks = 0; ks < 4; ++ks) {
                    const bf16x8 qa = *(const LAS bf16x8*)(ldA + R_Q + swz(16 * ti + l15, 4 * ks + g4));
                    const bf16x8 kb = *(const LAS bf16x8*)(ldA + R_K + swz(16 * tj + l15, 4 * ks + g4));
                    sa = __builtin_amdgcn_mfma_f32_16x16x32_bf16(qa, kb, sa, 0, 0, 0);
                }
                const int jj = 16 * tj + l15;
#pragma unroll
                for (int r = 0; r < 4; ++r) { const int ii = 16 * ti + 4 * g4 + r;
                    const float val = ii >= jj ? sa[r] * exp2f(lgv * (float)(ii - jj)) : 0.f;
                    *(LAS bf16_t*)((LAS unsigned char*)ldA + R_A + swza(ii, jj >> 3) + (jj & 7) * 2) = (bf16_t)(pk2(val, 0.f) & 0xffffu); }
            }
        }
        __syncthreads();
        bf16x8 vf[4]; int l3 = 0; LAUNDER(l3); const LAS unsigned char* const ldV = ldr + l3;
#pragma unroll
        for (int s = 0; s < 4; ++s) { const int r0 = 16 * s + 8 * hh + tq, ch = 4 * w + 2 * tblk + (tp >> 1);
            vf[s] = cat4(ldtr(ldV + R_V + swzv(r0, ch) + 8 * (tp & 1)), ldtr(ldV + R_V + swzv(r0 + 4, ch) + 8 * (tp & 1))); }
        f32x16 O2[2];
#pragma unroll
        for (int ib = 0; ib < 2; ++ib)
#pragma unroll
            for (int r = 0; r < 16; ++r) O2[ib][r] = 0.f;
#pragma unroll
        for (int db = 0; db < 4; ++db)
#pragma unroll
            for (int sp = 0; sp < 2; ++sp) {
                const int b = 8 * sp; int l4 = 0; LAUNDER(l4); const LAS unsigned char* const ldQ = ldr + l4;
                const u32x4 sw = (u32x4){pk2(Sacc[db][b], Sacc[db][b + 1]), pk2(Sacc[db][b + 2], Sacc[db][b + 3]), pk2(Sacc[db][b + 4], Sacc[db][b + 5]), pk2(Sacc[db][b + 6], Sacc[db][b + 7])};
                const bf16x8 sf = __builtin_bit_cast(bf16x8, sw);
#pragma unroll
                for (int ib = 0; ib < 2; ++ib) {
                    const u32x2 qlo = *(const LAS u32x2*)(ldQ + R_Q + swz(32 * ib + l31, 4 * db + 2 * sp) + 8 * hh);
                    const u32x2 qhi = *(const LAS u32x2*)(ldQ + R_Q + swz(32 * ib + l31, 4 * db + 2 * sp + 1) + 8 * hh);
                    const u32x4 qw = (u32x4){qlo.x, qlo.y, qhi.x, qhi.y};
                    O2[ib] = __builtin_amdgcn_mfma_f32_32x32x16_bf16(__builtin_bit_cast(bf16x8, qw), sf, O2[ib], 0, 0, 0);
                }
                __builtin_amdgcn_sched_barrier(0);
            }
#pragma unroll
        for (int ib = 0; ib < 2; ++ib) {
#pragma unroll
            for (int r = 0; r < 16; ++r) O2[ib][r] *= exp2f(lgv * (float)(32 * ib + crow(r, hh) + 1));
            int l5 = 0; LAUNDER(l5); const LAS unsigned char* const ldAA = ldr + l5;
#pragma unroll
            for (int s = 0; s < 4; ++s) { const bf16x8 af = *(const LAS bf16x8*)(ldAA + R_A + swza(32 * ib + l31, 2 * s + hh));
                O2[ib] = __builtin_amdgcn_mfma_f32_32x32x16_bf16(af, vf[s], O2[ib], 0, 0, 0); }
            __builtin_amdgcn_sched_barrier(0);
        }
#pragma unroll
        for (int db = 0; db < 4; ++db) {
#pragma unroll
            for (int r = 0; r < 16; ++r) Sacc[db][r] *= glen;
            int l6 = 0; LAUNDER(l6); const LAS unsigned char* const ldK = ldr + l6;
#pragma unroll
            for (int s = 0; s < 4; ++s) { const int r0 = 16 * s + 8 * hh + tq, ch = 4 * db + 2 * tblk + (tp >> 1);
                const bf16x8 kz = cat4(ldtr(ldK + R_KZ + swz(r0, ch) + 8 * (tp & 1)), ldtr(ldK + R_KZ + swz(r0 + 4, ch) + 8 * (tp & 1)));
                Sacc[db] = __builtin_amdgcn_mfma_f32_32x32x16_bf16(kz, vf[s], Sacc[db], 0, 0, 0); }
            __builtin_amdgcn_sched_barrier(0);
        }
        int l7 = 0; LAUNDER(l7); LAS unsigned char* const ldO = lds + l7;
#pragma unroll
        for (int ib = 0; ib < 2; ++ib)
#pragma unroll
            for (int r = 0; r < 16; ++r) { const int ii = 32 * ib + crow(r, hh); const float o = O2[ib][r];
                *(LAS bf16_t*)(ldO + R_O + (ii * 256 + 32 * w + l31) * 2) = (bf16_t)(pk2(o, 0.f) & 0xffffu); }
        __syncthreads();
        {
            const int row = tid >> 3, seg = tid & 7;
            float v[32], ss = 0.f;
#pragma unroll
            for (int q4 = 0; q4 < 4; ++q4) { unpk8(*(const LAS u32x4*)(ldO + R_O + (row * 256 + 32 * seg + 8 * q4) * 2), v + 8 * q4); }
#pragma unroll
            for (int e = 0; e < 32; ++e) ss += v[e] * v[e];
            ss += __shfl_xor(ss, 1); ss += __shfl_xor(ss, 2); ss += __shfl_xor(ss, 4);
            const float rr = rsqrtf(ss * (1.f / 256.f) + EPS);
            if (row < L) {
                bf16_t* gp = P.RD + (size_t)(crow0 + row) * 2048 + h * 256 + 32 * seg;
#pragma unroll
                for (int q4 = 0; q4 < 4; ++q4) { float gt[8], o[8]; unpk8(*(const u32x4*)(gp + 8 * q4), gt);
#pragma unroll
                    for (int e = 0; e < 8; ++e) o[e] = v[8 * q4 + e] * rr * P.rng[l7 + 32 * seg + 8 * q4 + e] * gt[e];
                    *(u32x4*)(gp + 8 * q4) = pk8(o); }
            }
        }
        __syncthreads();
    }
    unsigned so32 = (unsigned)((4 * (lane_o >> 5) * 256 + 32 * w + (lane_o & 31)) * 4); LAUNDER(so32);
#pragma unroll
    for (int db = 0; db < 4; ++db)
#pragma unroll
        for (int r = 0; r < 16; ++r) *(float*)((char*)sout + so32 + (unsigned)((32 * db + (r & 3) + 8 * (r >> 2)) * 1024)) = Sacc[db][r];
}

__device__ __forceinline__ void fixup_phase(const Args& a, int l) {
    unsigned char* ws = a.ws;
    const bf16_t* U = (const bf16_t*)(ws + P_U); bf16_t* Z = (bf16_t*)(ws + P_Z);
    const float* cw = a.in[I_CW] + (size_t)l * 3 * FF2; const float* cb = a.in[I_CB] + (size_t)l * FF2;
    const float* sc = a.in[I_SC] + (size_t)l * NSB * 2 * FF2;
    const int gt = blockIdx.x * 512 + threadIdx.x, GT = gridDim.x * 512;
    constexpr int CPR = FF / 8;
    for (int it = gt; it < M * CPR; it += GT) {
        const int row = it / CPR, c8 = (it - row * CPR) * 8;
        const bool smp = row >= MP; const int t = smp ? (row - MP) & 31 : row & (T - 1), b = smp ? (row - MP) >> 5 : 0;
        float z[8];
#pragma unroll
        for (int hv = 0; hv < 2; ++hv) {
            const int col = c8 + hv * FF;
            float u0[8], u1[8], u2[8];
            unpk8(*(const u32x4*)(U + (size_t)row * FF2 + col), u0);
            if (t >= 1) unpk8(*(const u32x4*)(U + (size_t)(row - 1) * FF2 + col), u1);
            else if (smp) { const f32x4 p0 = *(const f32x4*)(sc + ((size_t)b * 2 + 1) * FF2 + col), p1 = *(const f32x4*)(sc + ((size_t)b * 2 + 1) * FF2 + col + 4);
                u1[0] = p0.x; u1[1] = p0.y; u1[2] = p0.z; u1[3] = p0.w; u1[4] = p1.x; u1[5] = p1.y; u1[6] = p1.z; u1[7] = p1.w; }
            else {
#pragma unroll
                for (int e = 0; e < 8; ++e) u1[e] = 0.f;
            }
            if (t >= 2) unpk8(*(const u32x4*)(U + (size_t)(row - 2) * FF2 + col), u2);
            else if (smp) { const f32x4 p0 = *(const f32x4*)(sc + ((size_t)b * 2 + t) * FF2 + col), p1 = *(const f32x4*)(sc + ((size_t)b * 2 + t) * FF2 + col + 4);
                u2[0] = p0.x; u2[1] = p0.y; u2[2] = p0.z; u2[3] = p0.w; u2[4] = p1.x; u2[5] = p1.y; u2[6] = p1.z; u2[7] = p1.w; }
            else {
#pragma unroll
                for (int e = 0; e < 8; ++e) u2[e] = 0.f;
            }
#pragma unroll
            for (int e = 0; e < 8; ++e) {
                const float c = cb[col + e] + cw[col + e] * u2[e] + cw[FF2 + col + e] * u1[e] + cw[2 * FF2 + col + e] * u0[e];
                if (hv == 0) z[e] = c; else z[e] = c * sigmoidf_(c) * z[e];
            }
        }
        *(u32x4*)(Z + (size_t)row * FF + c8) = pk8(z);
    }
    float* scp = a.out + O_SCP + (size_t)l * NB * 2 * FF2; float* scs = a.out + O_SCS + (size_t)l * NSB * 2 * FF2;
    for (int it = gt; it < (NB + NSB) * 2 * FF2; it += GT) {
        const int col = it % FF2, rj = it / FF2;
        if (rj < NB * 2) { const int b = rj >> 1, j = rj & 1; scp[it] = bflo((unsigned)U[(size_t)(b * T + T - 2 + j) * FF2 + col]); }
        else { const int r2 = rj - NB * 2, b = r2 >> 1, j = r2 & 1; scs[(size_t)r2 * FF2 + col] = bflo((unsigned)U[(size_t)(MP + b * 32 + 30 + j) * FF2 + col]); }
    }
}

constexpr int LDS_BYTES = 131072 + 2048;
constexpr int N_PHASES = 1 + 7 * 2;
#ifndef PH_MASK
#define PH_MASK 0xff
#endif
#define PHT(t) (((PH_MASK) >> (t)) & 1)

__global__ void __launch_bounds__(512, 2) mega(Args a) {
    extern __shared__ __attribute__((aligned(16))) unsigned char lds_raw[];
    LAS unsigned char* lds = (LAS unsigned char*)lds_raw;
    cg::grid_group grid = cg::this_grid();
    const int lo = a.ph_lo, hi = a.ph_hi;
    unsigned char* ws = a.ws;
    const int G = gridDim.x, tid = threadIdx.x;
#define IN(k) (lo <= (k) && (k) < hi)
#define SEAM(k) do { if (IN(k) && IN((k) + 1)) grid.sync(); } while (0)
    if (PHT(0) && IN(0)) { p0_prologue(a, lds); }
    SEAM(0);
    float* stat = (float*)(ws + WS_STAT);
    bf16_t* XB = (bf16_t*)(ws + WS_XB);
#pragma unroll 1
    for (int l = 0; l < 2; ++l) {
        const int pb = 1 + 7 * l;
        unsigned char* wl = ws + WS_W + (size_t)l * W_LAYER;
        const float lam_init = l == 0 ? 0.2f : 0.35550906759096927f;
        if (PHT(1) && IN(pb)) {
            pg8::Gemm g{XB, (const bf16_t*)(wl + W_IN), M / 256, INW / 256, DM, DM}; pg8::Order S; S.init(M / 256, INW / 256, G, (int)blockIdx.x, 1);
            EpiIn E{stat, (bf16_t*)(ws + P_QR), (bf16_t*)(ws + P_KR), (bf16_t*)(ws + P_VR), (bf16_t*)(ws + P_RD), (bf16_t*)(ws + P_KD), (bf16_t*)(ws + P_VD), (bf16_t*)(ws + P_GA), (bf16_t*)(ws + P_GB),
                    a.out + O_KP + (size_t)l * MP * 1024, a.out + O_VP + (size_t)l * MP * 1024, a.out + O_KS + (size_t)l * MS * 1024, a.out + O_VS + (size_t)l * MS * 1024,
                    (const f32x2*)(ws + WS_RT), (const f32x2*)(ws + WS_DT), a.in[I_QNG] + l * 64, a.in[I_KNG] + l * 64};
            pg8::gemm_phase<EpiIn>(lds, g, S, E);
        }
        SEAM(pb);
        if (PHT(2) && IN(pb + 1)) {
            LAS float* misc = (LAS float*)(lds + 131072);
            if (tid < 64) {
                const float q1 = a.in[I_LQ1][l * 64 + tid] * a.in[I_LK1][l * 64 + tid], q2 = a.in[I_LQ2][l * 64 + tid] * a.in[I_LK2][l * 64 + tid];
                const float s1 = wave_sum(q1), s2 = wave_sum(q2);
                const float mq = wave_max(fabsf(a.in[I_QNG][l * 64 + tid])), mk = wave_max(fabsf(a.in[I_KNG][l * 64 + tid]));
                if (tid == 0) { misc[0] = expf(s1) - expf(s2) + lam_init; misc[1] = 8.f * mq * mk * LOG2E; }
            }
            __syncthreads();
            const float lam = misc[0], moff = misc[1];
            __syncthreads();
            RetP RP{(const bf16_t*)(ws + P_QR), (const bf16_t*)(ws + P_KR), (const bf16_t*)(ws + P_VR), (bf16_t*)(ws + P_RD), a.in[I_RNG] + l * 256,
                    a.in[I_SR] + (size_t)l * NSB * 4 * 128 * 256, a.out + O_SRP + (size_t)l * NB * 4 * 128 * 256, a.out + O_SRS + (size_t)l * NSB * 4 * 128 * 256};
#ifndef NO_RET
            for (int u = blockIdx.x; u < 160; u += G) ret_unit(lds, RP, u);
#endif
            AttnP AP{(bf16_t*)(ws + P_RD), (const bf16_t*)(ws + P_KD), (const bf16_t*)(ws + P_VD), (const bf16_t*)(ws + WS_CK + (size_t)l * CACHE_L), (const bf16_t*)(ws + WS_CV + (size_t)l * CACHE_L),
                     a.in[I_DNG] + l * 128, lam, moff, 1.f - lam_init};
            unsigned* ctr = (unsigned*)(ws + WS_CTL) + 64 * (1 + l);
            LAS int* ubox = (LAS int*)(lds + 131072 + 128);
            for (;;) {
                if (tid == 0) *ubox = (int)atomicAdd(ctr, 1u);
                __syncthreads();
                const int u = *ubox;
                __syncthreads();
                if (u >= 64 + 4096) break;
#ifndef NO_ATT
                attn_unit(lds, AP, u);
#endif
            }
        }
        SEAM(pb + 1);
        if (PHT(3) && IN(pb + 2)) {
            pg8::Gemm g{(const bf16_t*)(ws + P_RD), (const bf16_t*)(wl + W_AB), M / 256, 4, DM, 2048}; pg8::Order S; S.init(M / 256, 4, G, (int)blockIdx.x, 2);
            EpiBranch E{(const bf16_t*)(ws + P_GA), (const bf16_t*)(ws + P_GB), (float*)(ws + P_YP), (bf16_t*)(ws + P_Y)};
            pg8::gemm_phase<EpiBranch>(lds, g, S, E);
        }
        SEAM(pb + 2);
        if (PHT(4) && IN(pb + 3)) {
            pg8::Gemm g{(const bf16_t*)(ws + P_Y), (const bf16_t*)(wl + W_O), M / 256, 4, DM, DM}; pg8::Order S; S.init(M / 256, 4, G, (int)blockIdx.x, 1);
            EpiRes E{l == 0 ? a.in[I_XP] : a.out + O_YP, l == 0 ? a.in[I_XS] : a.out + O_YS, a.out + O_YP, a.out + O_YS, XB, stat, 1};
            pg8::gemm_phase<EpiRes>(lds, g, S, E);
        }
        SEAM(pb + 3);
        if (PHT(5) && IN(pb + 4)) {
            pg8::Gemm g{XB, (const bf16_t*)(wl + W_UP), M / 256, FF2 / 256, DM, DM}; pg8::Order S; S.init(M / 256, FF2 / 256, G, (int)blockIdx.x, 1);
            EpiUp E{stat, (bf16_t*)(ws + P_U)};
            pg8::gemm_phase<EpiUp>(lds, g, S, E);
        }
        SEAM(pb + 4);
        if (PHT(6) && IN(pb + 5)) fixup_phase(a, l);
        SEAM(pb + 5);
        if (PHT(7) && IN(pb + 6)) {
            pg8::Gemm g{(const bf16_t*)(ws + P_Z), (const bf16_t*)(wl + W_DN), M / 256, 4, FF, FF}; pg8::Order S; S.init(M / 256, 4, G, (int)blockIdx.x, 1);
            EpiRes E{a.out + O_YP, a.out + O_YS, a.out + O_YP, a.out + O_YS, XB, stat, l == 0 ? 1 : 0};
            pg8::gemm_phase<EpiRes>(lds, g, S, E);
        }
        SEAM(pb + 6);
    }
#undef IN
#undef SEAM
}

#ifndef N_LAUNCH_MODE
#define N_LAUNCH_MODE 1
#endif
extern "C" void kernel_launch(void* const* d_in, const int* in_sizes, int n_in, void* d_out, int out_size, void* d_ws, size_t ws_size, hipStream_t stream) {
    static int grid = 0;
    if (grid == 0) {
        int dev = 0, cus = 0;
        if (hipGetDevice(&dev) != hipSuccess || hipDeviceGetAttribute(&cus, hipDeviceAttributeMultiprocessorCount, dev) != hipSuccess) { grid = -1; }
        else if (hipFuncSetAttribute((const void*)mega, hipFuncAttributeMaxDynamicSharedMemorySize, LDS_BYTES) != hipSuccess) { grid = -1; }
        else {
            int per_cu = 0;
            if (hipOccupancyMaxActiveBlocksPerMultiprocessor(&per_cu, (const void*)mega, 512, LDS_BYTES) != hipSuccess || per_cu < 1) { (void)hipGetLastError(); per_cu = 1; }
            grid = cus;
        }
    }
    if (n_in != 24 || (size_t)out_size != O_END || ws_size < WS_END2 || grid <= 0) {
        fprintf(stderr, "kernel_launch: unexpected problem (n_in %d out %d ws %zu need %zu grid %d)\n", n_in, out_size, ws_size, (size_t)WS_END2, grid);
        (void)hipMemsetAsync(d_out, 0xFF, (size_t)out_size * 4, stream);
        return;
    }
    (void)hipMemsetAsync((char*)d_ws + WS_CTL, 0, CTL_BYTES, stream);
    Args a{};
    for (int i = 0; i < 24; ++i) a.in[i] = (const float*)d_in[i];
    a.out = (float*)d_out; a.ws = (unsigned char*)d_ws;
#if N_LAUNCH_MODE == 0
    a.ph_lo = 0; a.ph_hi = N_PHASES;
    void* args[] = {&a};
    hipError_t e = hipLaunchCooperativeKernel((const void*)mega, dim3(grid), dim3(512), args, LDS_BYTES, stream);
    if (e != hipSuccess) fprintf(stderr, "cooperative launch failed: %s (grid %d)\n", hipGetErrorString(e), grid);
#else
    for (int p = 0; p < N_PHASES; ++p) {
        a.ph_lo = p; a.ph_hi = p + 1;
        hipLaunchKernelGGL(mega, dim3(grid), dim3(512), LDS_BYTES, stream, a);
    }
#endif
}
```
